# Optimizing an MI355X kernel written in HIP

```python
import jax, jax.numpy as jnp
from jax import lax
import numpy as np

D_MODEL = 1024
BATCH = 2
SEQ = 8192
DEPTH = 1

CHUNK = 64
N_LEFT_CHUNKS = 8
BAND = (N_LEFT_CHUNKS + 1) * CHUNK
ATT_HEADS = 8
ATT_HEAD_DIM = 64
D_ATT = ATT_HEADS * ATT_HEAD_DIM
D_CONV = D_MODEL // 2
CONV_WIDTH = 3
MAX_REL = 128
N_REL = 2 * MAX_REL + 1
EPS = 1e-6
NEG_BIG = -1e30
IN_SIZES = (D_ATT, D_ATT, D_ATT, D_ATT, D_CONV, D_CONV, D_CONV, D_CONV, D_MODEL, D_MODEL)
IN_COLS = sum(IN_SIZES)
IN_SPLITS = tuple(int(s) for s in np.cumsum(IN_SIZES)[:-1])

kernel_name = "hybrid_chunk_attn_shortconv_gated_block"


def rmsnorm(x, g):
    xf = x.astype(jnp.float32)
    r = lax.rsqrt(jnp.mean(xf * xf, axis=-1, keepdims=True) + EPS)
    return (xf * r).astype(x.dtype) * g


def chunked_rel_attention(q, k, v, rel_bias):
    b, s, h, dh = q.shape
    nc = s // CHUNK
    qc = q.reshape(b, nc, CHUNK, h, dh)
    kc = k.reshape(b, nc, CHUNK, h, dh)
    vc = v.reshape(b, nc, CHUNK, h, dh)
    pad = ((0, 0), (N_LEFT_CHUNKS, 0), (0, 0), (0, 0), (0, 0))
    kp = jnp.pad(kc, pad)
    vp = jnp.pad(vc, pad)
    kb = jnp.concatenate([kp[:, j:j + nc] for j in range(N_LEFT_CHUNKS + 1)], axis=2)
    vb = jnp.concatenate([vp[:, j:j + nc] for j in range(N_LEFT_CHUNKS + 1)], axis=2)
    scale = ATT_HEAD_DIM ** -0.5
    scores = jnp.einsum('bcqhd,bckhd->bhcqk', qc, kb).astype(jnp.float32) * scale
    rel = np.arange(CHUNK)[:, None] + N_LEFT_CHUNKS * CHUNK - np.arange(BAND)[None, :]
    idx = np.clip(rel, -MAX_REL, MAX_REL) + MAX_REL
    bias = rel_bias[:, idx].astype(jnp.float32)
    kpos = np.arange(nc)[:, None] * CHUNK - N_LEFT_CHUNKS * CHUNK + np.arange(BAND)[None, :]
    valid = jnp.asarray(kpos >= 0)
    scores = jnp.where(valid[None, None, :, None, :], scores + bias[None, :, None], NEG_BIG)
    p = jax.nn.softmax(scores, axis=-1).astype(v.dtype)
    out = jnp.einsum('bhcqk,bckhd->bcqhd', p, vb)
    return out.reshape(b, s, h * dh)


def causal_depthwise_conv(u, w, bias):
    s = u.shape[1]
    up = jnp.pad(u, ((0, 0), (CONV_WIDTH - 1, 0), (0, 0)))
    return sum(w[t] * up[:, t:t + s] for t in range(CONV_WIDTH)) + bias


def setup_inputs(seed: int = 0) -> dict:
    key = jax.random.key(seed)
    ks = jax.random.split(key, 12)
    f32 = jnp.float32
    x = jax.random.normal(ks[0], (BATCH, SEQ, D_MODEL), f32)
    norm_g = 1.0 + 0.05 * jax.random.normal(ks[1], (DEPTH, D_MODEL), f32)
    w_in = jax.random.normal(ks[2], (DEPTH, D_MODEL, IN_COLS), f32) * D_MODEL ** -0.5
    rel_bias = 0.2 * jax.random.normal(ks[3], (DEPTH, ATT_HEADS, N_REL), f32)
    w_att_out = jax.random.normal(ks[4], (DEPTH, D_ATT, D_MODEL), f32) * D_ATT ** -0.5
    conv_w = jax.random.normal(ks[5], (DEPTH, CONV_WIDTH, D_CONV), f32) * CONV_WIDTH ** -0.5
    conv_b = 0.02 * jax.random.normal(ks[6], (DEPTH, D_CONV), f32)
    w_conv_out = jax.random.normal(ks[7], (DEPTH, D_CONV, D_MODEL), f32) * D_CONV ** -0.5
    w_out = jax.random.normal(ks[8], (DEPTH, D_MODEL, D_MODEL), f32) * D_MODEL ** -0.5
    final_norm_g = 1.0 + 0.05 * jax.random.normal(ks[9], (D_MODEL,), f32)
    return {"x": x, "norm_g": norm_g, "w_in": w_in, "rel_bias": rel_bias,
            "w_att_out": w_att_out, "conv_w": conv_w, "conv_b": conv_b,
            "w_conv_out": w_conv_out, "w_out": w_out, "final_norm_g": final_norm_g}


def reference(x, norm_g, w_in, rel_bias, w_att_out, conv_w, conv_b, w_conv_out, w_out, final_norm_g):
    b, s, _ = x.shape
    for l in range(DEPTH):
        h = rmsnorm(x, norm_g[l])
        proj = jnp.einsum('bsd,de->bse', h, w_in[l])
        q, k, v, z_att, gb, gc, u, z_conv, g_att, g_conv = jnp.split(proj, IN_SPLITS, axis=-1)
        att = chunked_rel_attention(q.reshape(b, s, ATT_HEADS, ATT_HEAD_DIM),
                                    k.reshape(b, s, ATT_HEADS, ATT_HEAD_DIM),
                                    v.reshape(b, s, ATT_HEADS, ATT_HEAD_DIM),
                                    rel_bias[l])
        y_att = jnp.einsum('bsc,cd->bsd', att * jax.nn.silu(z_att), w_att_out[l])
        vconv = causal_depthwise_conv(gc * u, conv_w[l], conv_b[l])
        y_conv = jnp.einsum('bsc,cd->bsd', gb * vconv * jax.nn.silu(z_conv), w_conv_out[l])
        m = jax.nn.sigmoid(g_att) * y_att + jax.nn.sigmoid(g_conv) * y_conv
        x = x + jnp.einsum('bsd,de->bse', m, w_out[l])
    return rmsnorm(x, final_norm_g)
```

```cpp
#include <hip/hip_runtime.h>
#include <hip/hip_cooperative_groups.h>
#include <cstdio>
#include <cstdint>
namespace cg = cooperative_groups;
namespace pg8 {
#define PG8_LAS __attribute__((address_space(3)))
typedef unsigned short bf16_t;
typedef short bf16x8 __attribute__((ext_vector_type(8)));
typedef float f32x4 __attribute__((ext_vector_type(4)));
typedef unsigned u32x4 __attribute__((ext_vector_type(4)));
constexpr int BM = 256, BK = 64, HALF = 128, HTB = HALF * BK * 2  , STAGE_BYTES = 8 * HTB, NXCD = 8, WGM = 8;

__host__ __device__ __forceinline__ int lds_byte(int r, int c) { const int st = (r >> 4) * 2 + (c >> 5), rr = r & 15, cc = c & 31, ob = rr * 64 + cc * 2; return st * 1024 + (ob ^ (((ob >> 9) & 1) << 5)); }
__host__ __device__ __forceinline__ void stage_rc(int b, int& R, int& C) { const int st = b / 1024, sb = b % 1024, swz = sb ^ (((sb >> 9) & 1) << 5); R = (st >> 1) * 16 + swz / 64; C = (st & 1) * 32 + (swz % 64) / 2; }
__host__ __device__ __forceinline__ int perm32(int rho) { const int n = rho >> 4, i = rho & 15; return 8 * (i >> 2) + 4 * n + (i & 3); }

struct Unit { int pm, pn; };
struct Gemm { const bf16_t* A; const bf16_t* Bt; int M, N, K; };

struct StaticOrder {
    int nM, nN, nwg, G, c;
    __host__ __device__ void init(int M, int N, int G_, int c_) { nM = M / BM; nN = N / BM; nwg = nM * nN; G = G_; c = c_; }
    __host__ __device__ bool next(int i, Unit& u) const {
        const long L = (long)i * G + c; if (L >= nwg) return false;
        int wgid = (int)L; { const int q = nwg / NXCD, r = nwg % NXCD, xcd = wgid % NXCD, off = wgid / NXCD; wgid = (xcd < r ? xcd * (q + 1) : r * (q + 1) + (xcd - r) * q) + off; }
        const int nig = WGM * nN, gid = wgid / nig, fm = gid * WGM, gsz = (nM - fm) < WGM ? (nM - fm) : WGM;
        u.pm = fm + ((wgid % nig) % gsz); u.pn = (wgid % nig) / gsz; return true;
    }
    __device__ __forceinline__ void a_ready(const Unit&) const {}
    __device__ __forceinline__ void done(const Unit&) const {}
};
__device__ __forceinline__ unsigned cvt_pk_bf16(float lo, float hi) { unsigned r; asm volatile("v_cvt_pk_bf16_f32 %0, %1, %2" : "=v"(r) : "v"(lo), "v"(hi)); return r; }
typedef float f32x2 __attribute__((ext_vector_type(2)));
constexpr float QSCALE = 0.125f * 1.4426950408889634f;
__device__ __forceinline__ float bf_lo(unsigned w) { return __uint_as_float(w << 16); }
__device__ __forceinline__ float bf_hi(unsigned w) { return __uint_as_float(w & 0xffff0000u); }
__device__ __forceinline__ float sigmoidf_(float x) { x = __builtin_fminf(__builtin_fmaxf(x, -30.f), 30.f); return __builtin_amdgcn_rcpf(1.0f + __builtin_amdgcn_exp2f(-1.4426950408889634f * x)); }

struct EpiP {
    static constexpr bool PERM = true, AFTER_DRAIN = false, MIDHOOK = false; static constexpr int MID_T = 0;
    bf16_t* QKV; bf16_t* REST;
    __device__ __forceinline__ void mid(f32x4 (&)[2][2][4][2], const Unit&, int, int, int, int) const {}
    __device__ __forceinline__ void operator()(const f32x4 (&acc)[2][2][4][2], const Unit& u, int wr, int wc, int fr, int fq) const {
        const int row0 = u.pm * BM + wr * 64 + fr; int colt = u.pn * BM; bf16_t* base; int ldc; float sc = 1.f;
        if (colt < 1536) { base = QKV; ldc = 1536; if (colt < 512) sc = QSCALE; } else { base = REST; ldc = 4608; colt -= 1536; }
        const int col0 = colt + wc * 32 + 8 * fq;
#pragma unroll
        for (int ai = 0; ai < 2; ++ai)
#pragma unroll
            for (int m = 0; m < 4; ++m) { bf16_t* rowp = base + (size_t)(row0 + ai * HALF + m * 16) * ldc + col0;
#pragma unroll
                for (int bj = 0; bj < 2; ++bj) { f32x4 v0 = acc[ai][bj][m][0] * sc, v1 = acc[ai][bj][m][1] * sc;
                    u32x4 w; w.x = cvt_pk_bf16(v0[0], v0[1]); w.y = cvt_pk_bf16(v0[2], v0[3]); w.z = cvt_pk_bf16(v1[0], v1[1]); w.w = cvt_pk_bf16(v1[2], v1[3]);
                    *(u32x4*)(rowp + bj * HALF) = w; } }
    }
};
struct EpiM {
    static constexpr bool PERM = true, AFTER_DRAIN = false, MIDHOOK = true; static constexpr int MID_T = 8;
    const bf16_t* REST; bf16_t* Mb;
    __device__ __forceinline__ void mid(f32x4 (&acc)[2][2][4][2], const Unit& u, int wr, int wc, int fr, int fq) const {
        const int row0 = u.pm * BM + wr * 64 + fr, col0 = u.pn * BM + wc * 32 + 8 * fq;
        const bf16_t* rp0 = REST + (size_t)row0 * 4608 + col0; asm volatile("" : "+v"(rp0));
#pragma unroll
        for (int ai = 0; ai < 2; ++ai)
#pragma unroll
            for (int m = 0; m < 4; ++m) { const bf16_t* rowp = rp0 + (size_t)(ai * HALF + m * 16) * 4608;
#pragma unroll
                for (int bj = 0; bj < 2; ++bj) { const u32x4 ga = *(const u32x4*)(rowp + 2560 + bj * HALF), gc = *(const u32x4*)(rowp + 3584 + bj * HALF);
                    float r[8];
#pragma unroll
                    for (int e = 0; e < 4; ++e) { const unsigned a = ga[e], c = gc[e];
                        r[2 * e] = sigmoidf_(bf_lo(a)) * (1.0f + __builtin_amdgcn_exp2f(-1.4426950408889634f * __builtin_fminf(__builtin_fmaxf(bf_lo(c), -30.f), 30.f)));
                        r[2 * e + 1] = sigmoidf_(bf_hi(a)) * (1.0f + __builtin_amdgcn_exp2f(-1.4426950408889634f * __builtin_fminf(__builtin_fmaxf(bf_hi(c), -30.f), 30.f))); }
                    acc[ai][bj][m][0] = acc[ai][bj][m][0] * (f32x4){r[0], r[1], r[2], r[3]}; acc[ai][bj][m][1] = acc[ai][bj][m][1] * (f32x4){r[4], r[5], r[6], r[7]}; }
                asm volatile("" ::: "memory"); }
    }
    __device__ __forceinline__ void operator()(const f32x4 (&acc)[2][2][4][2], const Unit& u, int wr, int wc, int fr, int fq) const {
        const int row0 = u.pm * BM + wr * 64 + fr, col0 = u.pn * BM + wc * 32 + 8 * fq;
#pragma unroll
        for (int ai = 0; ai < 2; ++ai)
#pragma unroll
            for (int m = 0; m < 4; ++m) { const size_t row = (size_t)(row0 + ai * HALF + m * 16);
#pragma unroll
                for (int bj = 0; bj < 2; ++bj) { const u32x4 gc = *(const u32x4*)(REST + row * 4608 + 3584 + col0 + bj * HALF);
                    f32x4 v0 = acc[ai][bj][m][0], v1 = acc[ai][bj][m][1];
                    v0 = v0 * (f32x4){sigmoidf_(bf_lo(gc[0])), sigmoidf_(bf_hi(gc[0])), sigmoidf_(bf_lo(gc[1])), sigmoidf_(bf_hi(gc[1]))};
                    v1 = v1 * (f32x4){sigmoidf_(bf_lo(gc[2])), sigmoidf_(bf_hi(gc[2])), sigmoidf_(bf_lo(gc[3])), sigmoidf_(bf_hi(gc[3]))};
                    u32x4 w; w.x = cvt_pk_bf16(v0[0], v0[1]); w.y = cvt_pk_bf16(v0[2], v0[3]); w.z = cvt_pk_bf16(v1[0], v1[1]); w.w = cvt_pk_bf16(v1[2], v1[3]);
                    *(u32x4*)(Mb + row * 1024 + col0 + bj * HALF) = w; }
                asm volatile("" ::: "memory"); }
    }
};
struct EpiV {
    static constexpr bool PERM = false, AFTER_DRAIN = false, MIDHOOK = false; static constexpr int MID_T = 0;
    const float* x; float* out; float* part;
    __device__ __forceinline__ void mid(f32x4 (&)[2][2][4][2], const Unit&, int, int, int, int) const {}
    __device__ __forceinline__ void operator()(const f32x4 (&acc)[2][2][4][2], const Unit& u, int wr, int wc, int fr, int fq) const {
        const int row0 = u.pm * BM + wr * 64 + fr, col0 = u.pn * BM + wc * 32 + 4 * fq;
#pragma unroll
        for (int ai = 0; ai < 2; ++ai)
#pragma unroll
            for (int m = 0; m < 4; ++m) { const size_t row = (size_t)(row0 + ai * HALF + m * 16); const size_t off = row * 1024 + col0; float s = 0.f;
#pragma unroll
                for (int bj = 0; bj < 2; ++bj)
#pragma unroll
                    for (int n = 0; n < 2; ++n) { const f32x4 xv = *(const f32x4*)(x + off + bj * HALF + n * 16); const f32x4 v = xv + acc[ai][bj][m][n];
                        s += (v[0] * v[0] + v[1] * v[1]) + (v[2] * v[2] + v[3] * v[3]); *(f32x4*)(out + off + bj * HALF + n * 16) = v; }
                s += __shfl_xor(s, 16); s += __shfl_xor(s, 32);
                if (fq == 0) part[row * 16 + u.pn * 4 + wc] = s; }
    }
};
template <class Epi, class Sched, bool ALIGN_EPI = false, bool SP2 = false>
__device__ __forceinline__ void gemm_phase(PG8_LAS unsigned char* lds, const Gemm g, const Sched& S, const Epi& E) {
    const int tid = threadIdx.x, wid = __builtin_amdgcn_readfirstlane(tid >> 6), lane = tid & 63, wr = wid >> 2, wc = wid & 3, fr = lane & 15, fq = lane >> 4;
    const int K = g.K, nt = K / BK;
    unsigned voffA[2], voffB[2];
#pragma unroll
    for (int i = 0; i < 2; ++i) { int R, C; stage_rc(tid * 16 + i * 8192, R, C); const int Rb = Epi::PERM ? ((R & ~31) + perm32(R & 31)) : R;
        voffA[i] = (unsigned)(R * K + C) * 2u; voffB[i] = (unsigned)(Rb * K + C) * 2u; }
    const size_t kstep = (size_t)(BK * 2);
    const size_t hstep = (size_t)HALF * K * 2;
    const size_t tstep = 2 * hstep;
    const unsigned ldsw = (unsigned)wid * 1024u;
    const int aoff = lds_byte(wr * 64 + fr, fq * 8), boff = lds_byte(wc * 32 + fr, fq * 8);
#define PG8_SA(b, h) (((b) * 2 + (h)) * HTB)
#define PG8_SB(b, h) ((4 + (b) * 2 + (h)) * HTB)
#define PG8_STAGE(bufoff, gbase, voff) do { _Pragma("unroll") for (int _i = 0; _i < 2; ++_i) \
        __builtin_amdgcn_global_load_lds((const unsigned*)((const char*)(gbase) + (voff)[_i]), (PG8_LAS unsigned*)(lds + (bufoff) + ldsw + _i * 8192), 16, 0, 0); } while (0)
#define PG8_LDA(dst, b, h) do { _Pragma("unroll") for (int m = 0; m < 4; ++m) _Pragma("unroll") for (int k = 0; k < 2; ++k) dst[m][k] = *(const PG8_LAS bf16x8*)(lds + PG8_SA(b, h) + aoff + m * 2048 + k * 1024); } while (0)
#define PG8_LDB(dst, b, h) do { _Pragma("unroll") for (int n = 0; n < 2; ++n) _Pragma("unroll") for (int k = 0; k < 2; ++k) dst[n][k] = *(const PG8_LAS bf16x8*)(lds + PG8_SB(b, h) + boff + n * 2048 + k * 1024); } while (0)
#define PG8_MMA(ai, bj, At, Bt) do { __builtin_amdgcn_s_setprio(1); _Pragma("unroll") for (int m = 0; m < 4; ++m) _Pragma("unroll") for (int n = 0; n < 2; ++n) _Pragma("unroll") for (int k = 0; k < 2; ++k) \
        acc[ai][bj][m][n] = __builtin_amdgcn_mfma_f32_16x16x32_bf16(Bt[n][k], At[m][k], acc[ai][bj][m][n], 0, 0, 0); __builtin_amdgcn_s_setprio(0); } while (0)
#define PG8_WAIT_V(n) asm volatile("s_waitcnt vmcnt(" #n ")" ::: "memory")
#define PG8_WAIT_L(n) asm volatile("s_waitcnt lgkmcnt(" #n ")" ::: "memory")
#define PG8_BAR __builtin_amdgcn_s_barrier()
#define PG8_SCHED __builtin_amdgcn_sched_barrier(0)
    Unit cur, nxt; int ui = 0;
    if (!S.next(0, cur)) return;
    f32x4 acc[2][2][4][2];
#pragma unroll
    for (int a = 0; a < 2; ++a)
#pragma unroll
        for (int b = 0; b < 2; ++b)
#pragma unroll
            for (int m = 0; m < 4; ++m)
#pragma unroll
                for (int n = 0; n < 2; ++n) acc[a][b][m][n] = (f32x4){0.f, 0.f, 0.f, 0.f};
    bf16x8 At[4][2], B0[2][2], B1[2][2];
    const char* cA = (const char*)g.A + (size_t)cur.pm * tstep; const char* cB = (const char*)g.Bt + (size_t)cur.pn * tstep;
    S.a_ready(cur);
    if constexpr (SP2) {
        PG8_STAGE(PG8_SB(0, 0), cB, voffB); PG8_STAGE(PG8_SB(0, 1), cB + hstep, voffB); PG8_STAGE(PG8_SA(0, 0), cA, voffA); PG8_STAGE(PG8_SA(0, 1), cA + hstep, voffA);
        if (wr == 1) PG8_BAR;
        PG8_WAIT_V(2); PG8_BAR;
        PG8_STAGE(PG8_SB(1, 0), cB + kstep, voffB); PG8_STAGE(PG8_SA(1, 0), cA + kstep, voffA); PG8_STAGE(PG8_SB(1, 1), cB + hstep + kstep, voffB);
        PG8_WAIT_V(6); PG8_BAR;
    } else {
        PG8_STAGE(PG8_SB(0, 0), cB, voffB); PG8_STAGE(PG8_SA(0, 0), cA, voffA); PG8_STAGE(PG8_SB(0, 1), cB + hstep, voffB); PG8_STAGE(PG8_SA(0, 1), cA + hstep, voffA);
        if (wr == 1) PG8_BAR;
        PG8_WAIT_V(4); PG8_BAR;
        PG8_STAGE(PG8_SB(1, 0), cB + kstep, voffB); PG8_STAGE(PG8_SA(1, 0), cA + kstep, voffA); PG8_STAGE(PG8_SB(1, 1), cB + hstep + kstep, voffB);
        PG8_WAIT_V(6); PG8_BAR;
    }
    for (;;) {
        const bool has_next = S.next(ui + 1, nxt);
        const char* nA = has_next ? (const char*)g.A + (size_t)nxt.pm * tstep : cA; const char* nB = has_next ? (const char*)g.Bt + (size_t)nxt.pn * tstep : cB;
        for (int t = 0; t < nt; t += 2) {
            if constexpr (Epi::MIDHOOK) { if (t == Epi::MID_T) E.mid(acc, cur, wr, wc, fr, fq); }
            const bool last = (t == nt - 2);
            const char* a1 = cA + (size_t)(t + 1) * kstep;
            const char* a2 = last ? nA : cA + (size_t)(t + 2) * kstep; const char* b2 = last ? nB : cB + (size_t)(t + 2) * kstep;
            const char* a3 = a2 + kstep; const char* b3 = b2 + kstep;
            if (last && has_next) S.a_ready(nxt);
            if constexpr (SP2) {
            PG8_LDB(B0, 0, 0); PG8_LDB(B1, 0, 1); PG8_SCHED; PG8_LDA(At, 0, 0); PG8_STAGE(PG8_SA(1, 1), a1 + hstep, voffA);
            PG8_WAIT_V(8); PG8_WAIT_L(0); PG8_BAR; PG8_MMA(0, 0, At, B0); PG8_MMA(0, 1, At, B1); PG8_BAR; PG8_SCHED;
            PG8_LDA(At, 0, 1); PG8_STAGE(PG8_SB(0, 0), b2, voffB); PG8_STAGE(PG8_SB(0, 1), b2 + hstep, voffB); PG8_STAGE(PG8_SA(0, 0), a2, voffA);
            PG8_WAIT_V(8); PG8_WAIT_L(0); PG8_BAR; PG8_MMA(1, 0, At, B0); PG8_MMA(1, 1, At, B1); PG8_BAR; PG8_SCHED;
            PG8_LDB(B0, 1, 0); PG8_LDB(B1, 1, 1); PG8_SCHED; PG8_LDA(At, 1, 0); PG8_STAGE(PG8_SA(0, 1), a2 + hstep, voffA);
            PG8_WAIT_V(8); PG8_WAIT_L(0); PG8_BAR; PG8_MMA(0, 0, At, B0); PG8_MMA(0, 1, At, B1); PG8_BAR; PG8_SCHED;
            PG8_LDA(At, 1, 1); PG8_STAGE(PG8_SB(1, 0), b3, voffB); PG8_STAGE(PG8_SB(1, 1), b3 + hstep, voffB); PG8_STAGE(PG8_SA(1, 0), a3, voffA);
            PG8_WAIT_V(8); PG8_WAIT_L(0); PG8_BAR; PG8_MMA(1, 0, At, B0); PG8_MMA(1, 1, At, B1); PG8_BAR; PG8_SCHED;
            } else {
            PG8_LDB(B0, 0, 0); PG8_SCHED; PG8_LDA(At, 0, 0); PG8_STAGE(PG8_SA(1, 1), a1 + hstep, voffA);
            PG8_WAIT_L(8); PG8_BAR; PG8_WAIT_L(0); PG8_MMA(0, 0, At, B0); PG8_BAR; PG8_SCHED;
            PG8_LDB(B1, 0, 1); PG8_STAGE(PG8_SB(0, 0), b2, voffB);
            PG8_BAR; PG8_WAIT_L(0); PG8_MMA(0, 1, At, B1); PG8_BAR;
            PG8_LDA(At, 0, 1); PG8_STAGE(PG8_SA(0, 0), a2, voffA);
            PG8_BAR; PG8_WAIT_L(0); PG8_MMA(1, 0, At, B0); PG8_BAR; PG8_SCHED;
            PG8_STAGE(PG8_SB(0, 1), b2 + hstep, voffB);
            PG8_WAIT_V(6); PG8_BAR; PG8_MMA(1, 1, At, B1); PG8_BAR;
            PG8_LDB(B0, 1, 0); PG8_SCHED; PG8_LDA(At, 1, 0); PG8_STAGE(PG8_SA(0, 1), a2 + hstep, voffA);
            PG8_WAIT_L(8); PG8_BAR; PG8_WAIT_L(0); PG8_MMA(0, 0, At, B0); PG8_BAR; PG8_SCHED;
            PG8_LDB(B1, 1, 1); PG8_STAGE(PG8_SB(1, 0), b3, voffB);
            PG8_BAR; PG8_WAIT_L(0); PG8_MMA(0, 1, At, B1); PG8_BAR;
            PG8_LDA(At, 1, 1); PG8_STAGE(PG8_SA(1, 0), a3, voffA);
            PG8_BAR; PG8_WAIT_L(0); PG8_MMA(1, 0, At, B0); PG8_BAR; PG8_SCHED;
            PG8_STAGE(PG8_SB(1, 1), b3 + hstep, voffB);
            PG8_WAIT_V(6); PG8_BAR; PG8_MMA(1, 1, At, B1); PG8_BAR;
            }
        }
        if constexpr (ALIGN_EPI) { if (wr == 0) PG8_BAR; }
        if constexpr (!Epi::AFTER_DRAIN) { E(acc, cur, wr, wc, fr, fq); S.done(cur); }
        if (!has_next) break;
#pragma unroll
        for (int a = 0; a < 2; ++a)
#pragma unroll
            for (int b = 0; b < 2; ++b)
#pragma unroll
                for (int m = 0; m < 4; ++m)
#pragma unroll
                    for (int n = 0; n < 2; ++n) acc[a][b][m][n] = (f32x4){0.f, 0.f, 0.f, 0.f};
        cur = nxt; cA = nA; cB = nB; ++ui;
        if constexpr (ALIGN_EPI) { if (wr == 1) PG8_BAR; }
    }
    PG8_WAIT_V(0);
    if constexpr (!ALIGN_EPI) { if (wr == 0) PG8_BAR; }
    PG8_BAR;
    if constexpr (Epi::AFTER_DRAIN) { E.fused(acc, cur, wr, wc, fr, fq, lds, wid, lane); S.done(cur); }
#undef PG8_SA
#undef PG8_SB
#undef PG8_STAGE
#undef PG8_LDA
#undef PG8_LDB
#undef PG8_MMA
#undef PG8_WAIT_V
#undef PG8_WAIT_L
#undef PG8_BAR
#undef PG8_SCHED
}
}
#define LAS __attribute__((address_space(3)))
typedef unsigned short bf16;
typedef unsigned v4u __attribute__((ext_vector_type(4)));
typedef float f32x4 __attribute__((ext_vector_type(4)));
typedef float f32x16 __attribute__((ext_vector_type(16)));
typedef short bf16x8 __attribute__((ext_vector_type(8)));
typedef short s16x4 __attribute__((ext_vector_type(4)));
constexpr int NWAVES = 8, NTHR = 512;
constexpr int BATCH = 2, SEQ = 8192, D = 1024, M = BATCH * SEQ, NIN = 6144, DQKV = 1536, DREST = 4608, NH = 8;
constexpr float EPS = 1e-6f, LOG2E = 1.4426950408889634f;
constexpr size_t MiB = 1u << 20;
constexpr size_t WS_WIN = 2 * MiB, WS_BT2 = 14 * MiB, WS_WOUT = 16 * MiB, WS_PART = 18 * MiB, WS_XN = 20 * MiB, WS_QKV = 52 * MiB, WS_REST = 100 * MiB, WS_END = 244 * MiB;
constexpr size_t WS_A2 = WS_XN, WS_MB = WS_QKV;
constexpr int LDS_BYTES = 147456;

__device__ __forceinline__ unsigned f2bf(float f) { unsigned u = __builtin_bit_cast(unsigned, f); return (u + 0x7fffu + ((u >> 16) & 1u)) >> 16; }
__device__ __forceinline__ unsigned pk2(float lo, float hi) { return f2bf(lo) | (f2bf(hi) << 16); }
__device__ __forceinline__ float blo(unsigned w) { return __uint_as_float(w << 16); }
__device__ __forceinline__ float bhi(unsigned w) { return __uint_as_float(w & 0xffff0000u); }
__device__ __forceinline__ float wave_sum(float v) {
#pragma unroll
    for (int o = 1; o < 64; o <<= 1) v += __shfl_xor(v, o);
    return v;
}
#define LDS_WAIT() asm volatile("s_waitcnt lgkmcnt(0)" ::: "memory")

__device__ __forceinline__ void p0_transpose_item(const float* W, int N, bf16* WT, int ldk, int koff, LAS float* scr, int item, int lane) {
    const int nblk = N / 32, kb = item / nblk, nb = item % nblk, k0 = 64 * kb, n0 = 32 * nb;
#pragma unroll 8
    for (int i = 0; i < 32; ++i) { const int kk = 2 * i + (lane >> 5); scr[kk * 33 + (lane & 31)] = W[(size_t)(k0 + kk) * N + n0 + (lane & 31)]; }
    LDS_WAIT();
    const int c = lane & 7;
#pragma unroll
    for (int j = 0; j < 4; ++j) { const int n = (lane >> 3) + 8 * j; const LAS float* s = scr + (8 * c) * 33 + n;
        v4u o; o.x = pk2(s[0 * 33], s[1 * 33]); o.y = pk2(s[2 * 33], s[3 * 33]); o.z = pk2(s[4 * 33], s[5 * 33]); o.w = pk2(s[6 * 33], s[7 * 33]);
        *(v4u*)(WT + (size_t)(n0 + n) * ldk + koff + k0 + 8 * c) = o; }
    LDS_WAIT();
}
struct Ptrs {
    const float *x, *norm_g, *w_in, *rel_bias, *w_att_out, *conv_w, *conv_b, *w_conv_out, *w_out, *final_g; float* out;
    bf16 *WinT, *Bt2, *WoutT, *XN, *QKV, *REST, *A2, *Mb; float* part;
};
__device__ __forceinline__ void p0_prologue(const Ptrs& F, LAS unsigned char* lds, int gw, int NGW, int wave, int lane) {
    LAS float* scr = (LAS float*)(lds + wave * 16384);
    constexpr int I_IN = (D / 64) * (NIN / 32), I_AO = (512 / 64) * (D / 32), I_CO = I_AO, I_OUT = (D / 64) * (D / 32);
    constexpr int NITEMS = I_IN + I_AO + I_CO + I_OUT;
    for (int it = gw; it < NITEMS; it += NGW) {
        int r = it;
        if (r < I_IN) { p0_transpose_item(F.w_in, NIN, F.WinT, D, 0, scr, r, lane); continue; } r -= I_IN;
        if (r < I_AO) { p0_transpose_item(F.w_att_out, D, F.Bt2, D, 0, scr, r, lane); continue; } r -= I_AO;
        if (r < I_CO) { p0_transpose_item(F.w_conv_out, D, F.Bt2, D, 512, scr, r, lane); continue; } r -= I_CO;
        p0_transpose_item(F.w_out, D, F.WoutT, D, 0, scr, r, lane);
    }
    f32x4 g[4];
#pragma unroll
    for (int j = 0; j < 4; ++j) g[j] = ((const f32x4*)F.norm_g)[lane + 64 * j];
    for (int m = gw; m < M; m += NGW) {
        const f32x4* xr = (const f32x4*)(F.x + (size_t)m * D) + lane; f32x4 v[4]; float s = 0.f;
#pragma unroll
        for (int j = 0; j < 4; ++j) { v[j] = xr[64 * j]; s += (v[j].x * v[j].x + v[j].y * v[j].y) + (v[j].z * v[j].z + v[j].w * v[j].w); }
        const float r = 1.0f / sqrtf(wave_sum(s) * (1.f / D) + EPS);
        unsigned long long* o8 = (unsigned long long*)(F.XN + (size_t)m * D) + lane;
#pragma unroll
        for (int j = 0; j < 4; ++j) { const f32x4 h = v[j] * r * g[j]; o8[64 * j] = (unsigned long long)pk2(h.x, h.y) | ((unsigned long long)pk2(h.z, h.w) << 32); }
    }
}

namespace att {
constexpr int SLOT = 16384, OFF_TAB = 2 * SLOT, OFF_SCR = OFF_TAB + 2048, ATT_LDS = OFF_SCR + NWAVES * 256;
__device__ __forceinline__ int crow(int r, int hi) { return (r & 3) + 8 * (r >> 2) + 4 * hi; }
__device__ __forceinline__ void unit(const Ptrs& F, LAS unsigned char* lds, int b, int h, int g) {
    const int tid = threadIdx.x, lane = tid & 63, r = lane & 31, hi = lane >> 5; const int wid = __builtin_amdgcn_readfirstlane(tid >> 6);
    const size_t rowbase = (size_t)b * SEQ;
    const int o = wid >> 1, tq0 = 256 * g + 32 * wid, qi = 32 * (wid & 1) + r;
    LAS float* tab = (LAS float*)(lds + OFF_TAB); LAS float* scr = (LAS float*)(lds + OFF_SCR + wid * 256);
    __syncthreads();
    if (tid < 257) tab[tid] = F.rel_bias[h * 257 + tid] * LOG2E;
    bf16x8 qr[4];
    { const bf16* qp = F.QKV + (rowbase + tq0 + r) * DQKV + h * 64 + hi * 8;
#pragma unroll
      for (int d0 = 0; d0 < 4; ++d0) qr[d0] = *(const bf16x8*)(qp + d0 * 16); }
    const int jlo = (4 * g >= 8) ? 0 : 8 - 4 * g;
    const bf16* ksrc = F.QKV + (rowbase + (size_t)(tid & 63)) * DQKV + 512 + h * 64 + (tid >> 6) * 8;
    const bf16* vsrc = F.QKV + (rowbase + (size_t)(tid >> 3)) * DQKV + 1024 + h * 64 + (tid & 7) * 8;
    const int kdst = tid * 16, vdst = 8192 + ((tid & 7) >> 2) * 4096 + (tid >> 3) * 64 + (tid & 3) * 16;
    v4u kreg, vreg;
    { const size_t toff = (size_t)(64 * (4 * g - 8 + jlo)) * DQKV; kreg = *(const v4u*)(ksrc + toff); vreg = *(const v4u*)(vsrc + toff); }
    *(LAS v4u*)(lds + (jlo & 1) * SLOT + kdst) = kreg; *(LAS v4u*)(lds + (jlo & 1) * SLOT + vdst) = vreg;
    __syncthreads();
    float mrun = -1e30f, lrun = 0.f; f32x16 oacc[2]; oacc[0] = f32x16{}; oacc[1] = f32x16{};
    const int kbase = hi * 1024 + r * 16;
    const int vbase = 8192 + ((lane >> 4) & 1) * 32 + (lane & 3) * 8 + (4 * hi + ((lane & 15) >> 2)) * 64;
    for (int jj = jlo; jj < 12; ++jj) {
        const int slot = (jj & 1) * SLOT;
        if (jj + 1 < 12) { const size_t toff = (size_t)(64 * (4 * g - 8 + jj + 1)) * DQKV; kreg = *(const v4u*)(ksrc + toff); vreg = *(const v4u*)(vsrc + toff); }
        const int d = o + 8 - jj;
        if (d >= 0 && d <= 8) {
            f32x16 p0 = f32x16{}, p1 = f32x16{};
#pragma unroll
            for (int d0 = 0; d0 < 4; ++d0) {
                const bf16x8 k0 = *(const LAS bf16x8*)(lds + slot + kbase + d0 * 2048), k1 = *(const LAS bf16x8*)(lds + slot + kbase + d0 * 2048 + 512);
                p0 = __builtin_amdgcn_mfma_f32_32x32x16_bf16(k0, qr[d0], p0, 0, 0, 0); p1 = __builtin_amdgcn_mfma_f32_32x32x16_bf16(k1, qr[d0], p1, 0, 0, 0); }
            if (d >= 3) { const float cb = tab[256];
#pragma unroll
                for (int i = 0; i < 16; ++i) { p0[i] += cb; p1[i] += cb; } }
            else { const int rb = 64 * d + qi + 128;
#pragma unroll
                for (int i = 0; i < 16; ++i) { const int i0 = rb - crow(i, hi), i1 = i0 - 32; p0[i] += tab[i0 > 256 ? 256 : i0]; p1[i] += tab[i1 > 256 ? 256 : i1]; } }
            float rm = p0[0];
#pragma unroll
            for (int i = 1; i < 16; ++i) rm = __builtin_fmaxf(rm, p0[i]);
#pragma unroll
            for (int i = 0; i < 16; ++i) rm = __builtin_fmaxf(rm, p1[i]);
            rm = __builtin_fmaxf(rm, __shfl_xor(rm, 32));
            const float mnew = __builtin_fmaxf(mrun, rm), f = __builtin_amdgcn_exp2f(mrun - mnew); mrun = mnew;
            float s = 0.f;
#pragma unroll
            for (int i = 0; i < 16; ++i) { p0[i] = __builtin_amdgcn_exp2f(p0[i] - mnew); p1[i] = __builtin_amdgcn_exp2f(p1[i] - mnew); s += p0[i] + p1[i]; }
            lrun = lrun * f + s;
            if (hi == 0) scr[r] = f;
            LDS_WAIT();
#pragma unroll
            for (int q4 = 0; q4 < 4; ++q4) { const f32x4 fv = *(const LAS f32x4*)(scr + 8 * q4 + 4 * hi);
#pragma unroll
                for (int e = 0; e < 4; ++e) { oacc[0][4 * q4 + e] *= fv[e]; oacc[1][4 * q4 + e] *= fv[e]; } }
            bf16x8 pa[4];
#pragma unroll
            for (int s4 = 0; s4 < 4; ++s4) { v4u w;
#pragma unroll
                for (int e = 0; e < 4; ++e) { const float a = (s4 < 2) ? p0[8 * (s4 & 1) + 2 * e] : p1[8 * (s4 & 1) + 2 * e], c = (s4 < 2) ? p0[8 * (s4 & 1) + 2 * e + 1] : p1[8 * (s4 & 1) + 2 * e + 1]; w[e] = pg8::cvt_pk_bf16(a, c); }
                pa[s4] = __builtin_bit_cast(bf16x8, w); }
#pragma unroll
            for (int dh = 0; dh < 2; ++dh)
#pragma unroll
                for (int s4 = 0; s4 < 4; ++s4) {
                    const s16x4 lo = __builtin_bit_cast(s16x4, __builtin_amdgcn_ds_read_tr16_b64_v4i16((LAS s16x4*)(lds + slot + vbase + dh * 4096 + s4 * 1024)));
                    const s16x4 hh = __builtin_bit_cast(s16x4, __builtin_amdgcn_ds_read_tr16_b64_v4i16((LAS s16x4*)(lds + slot + vbase + dh * 4096 + s4 * 1024 + 512)));
                    const bf16x8 vf = (bf16x8){lo[0], lo[1], lo[2], lo[3], hh[0], hh[1], hh[2], hh[3]};
                    oacc[dh] = __builtin_amdgcn_mfma_f32_32x32x16_bf16(pa[s4], vf, oacc[dh], 0, 0, 0); }
        }
        if (jj + 1 < 12) { *(LAS v4u*)(lds + ((jj + 1) & 1) * SLOT + kdst) = kreg; *(LAS v4u*)(lds + ((jj + 1) & 1) * SLOT + vdst) = vreg; }
        __syncthreads();
    }
    lrun += __shfl_xor(lrun, 32);
    if (hi == 0) scr[32 + r] = 1.0f / lrun;
    LDS_WAIT();
#pragma unroll
    for (int q4 = 0; q4 < 4; ++q4) { const f32x4 iv = *(const LAS f32x4*)(scr + 32 + 8 * q4 + 4 * hi);
#pragma unroll
        for (int e = 0; e < 4; ++e) { const size_t row = rowbase + tq0 + 8 * q4 + 4 * hi + e;
#pragma unroll
            for (int dh = 0; dh < 2; ++dh) { const int col = h * 64 + dh * 32 + r;
                const float z = __uint_as_float((unsigned)F.REST[row * DREST + col] << 16);
                const float sz = z * __builtin_amdgcn_rcpf(1.0f + __builtin_amdgcn_exp2f(-LOG2E * z));
                F.A2[row * D + col] = (bf16)f2bf(oacc[dh][4 * q4 + e] * iv[e] * sz); } } }
}
}

__device__ __forceinline__ void conv_phase(const Ptrs& F, int gtid, int NGT) {
    for (int it = gtid; it < (M / 8) * 64; it += NGT) {
        const int cg8 = it & 63, tb = it >> 6, c0 = cg8 * 8; const int t0 = tb * 8;
        float w0[8], w1[8], w2[8], bb[8];
#pragma unroll
        for (int e = 0; e < 8; ++e) { w0[e] = F.conv_w[c0 + e]; w1[e] = F.conv_w[512 + c0 + e]; w2[e] = F.conv_w[1024 + c0 + e]; bb[e] = F.conv_b[c0 + e]; }
        float cm2[8], cm1[8];
#pragma unroll
        for (int e = 0; e < 8; ++e) { cm2[e] = 0.f; cm1[e] = 0.f; }
        if ((t0 & (SEQ - 1)) != 0) {
            const bf16* p2 = F.REST + (size_t)(t0 - 2) * DREST + c0; const bf16* p1 = p2 + DREST;
            const v4u g2 = *(const v4u*)(p2 + 1024), u2 = *(const v4u*)(p2 + 1536), g1 = *(const v4u*)(p1 + 1024), u1 = *(const v4u*)(p1 + 1536);
#pragma unroll
            for (int e = 0; e < 4; ++e) { cm2[2 * e] = blo(g2[e]) * blo(u2[e]); cm2[2 * e + 1] = bhi(g2[e]) * bhi(u2[e]); cm1[2 * e] = blo(g1[e]) * blo(u1[e]); cm1[2 * e + 1] = bhi(g1[e]) * bhi(u1[e]); }
        }
#pragma unroll
        for (int tt = 0; tt < 8; ++tt) {
            const bf16* p = F.REST + (size_t)(t0 + tt) * DREST + c0;
            const v4u gb = *(const v4u*)(p + 512), gc = *(const v4u*)(p + 1024), uu = *(const v4u*)(p + 1536), zc = *(const v4u*)(p + 2048);
            float cur[8], res[8];
#pragma unroll
            for (int e = 0; e < 4; ++e) { cur[2 * e] = blo(gc[e]) * blo(uu[e]); cur[2 * e + 1] = bhi(gc[e]) * bhi(uu[e]); }
#pragma unroll
            for (int e = 0; e < 8; ++e) { const float gbv = (e & 1) ? bhi(gb[e >> 1]) : blo(gb[e >> 1]); const float z = (e & 1) ? bhi(zc[e >> 1]) : blo(zc[e >> 1]);
                const float vc = w0[e] * cm2[e] + w1[e] * cm1[e] + w2[e] * cur[e] + bb[e];
                res[e] = gbv * vc * z * __builtin_amdgcn_rcpf(1.0f + __builtin_amdgcn_exp2f(-LOG2E * z)); cm2[e] = cm1[e]; cm1[e] = cur[e]; }
            v4u ov; ov.x = pk2(res[0], res[1]); ov.y = pk2(res[2], res[3]); ov.z = pk2(res[4], res[5]); ov.w = pk2(res[6], res[7]);
            *(v4u*)(F.A2 + (size_t)(t0 + tt) * D + 512 + c0) = ov;
        }
    }
}
__device__ __forceinline__ void final_norm(const Ptrs& F, int gw, int NGW, int lane) {
    f32x4 g[4];
#pragma unroll
    for (int j = 0; j < 4; ++j) g[j] = ((const f32x4*)F.final_g)[lane + 64 * j];
    for (int m = gw; m < M; m += NGW) {
        const f32x4* pp = (const f32x4*)(F.part + (size_t)m * 16); const f32x4 a = pp[0], b = pp[1], c = pp[2], d = pp[3];
        const float ss = ((a.x + a.y) + (a.z + a.w)) + ((b.x + b.y) + (b.z + b.w)) + ((c.x + c.y) + (c.z + c.w)) + ((d.x + d.y) + (d.z + d.w));
        const float r = 1.0f / sqrtf(ss * (1.f / D) + EPS);
        f32x4* o = (f32x4*)(F.out + (size_t)m * D) + lane;
#pragma unroll
        for (int j = 0; j < 4; ++j) o[64 * j] = o[64 * j] * r * g[j];
    }
}

#ifndef MK_N_LAUNCHES
#define MK_N_LAUNCHES 6
#endif
constexpr int NPHASE = 6;
struct Args { const float* in[10]; float* out; unsigned char* ws; int ph_lo, ph_hi; };
__global__ void __launch_bounds__(NTHR, 2) fwd_megakernel(Args args) {
    extern __shared__ __attribute__((aligned(16))) unsigned char lds_raw[];
    LAS unsigned char* lds = (LAS unsigned char*)lds_raw;
    cg::grid_group grid = cg::this_grid();
    const int tid = threadIdx.x, lane = tid & 63, wave = __builtin_amdgcn_readfirstlane(tid >> 6);
    const int G = gridDim.x, bx = blockIdx.x;
    const int vcu = (G % 8 == 0) ? (bx % 8) * (G / 8) + bx / 8 : bx;
    Ptrs F;
    F.x = args.in[0]; F.norm_g = args.in[1]; F.w_in = args.in[2]; F.rel_bias = args.in[3]; F.w_att_out = args.in[4]; F.conv_w = args.in[5]; F.conv_b = args.in[6];
    F.w_conv_out = args.in[7]; F.w_out = args.in[8]; F.final_g = args.in[9]; F.out = args.out;
    unsigned char* ws = args.ws;
    F.WinT = (bf16*)(ws + WS_WIN); F.Bt2 = (bf16*)(ws + WS_BT2); F.WoutT = (bf16*)(ws + WS_WOUT); F.part = (float*)(ws + WS_PART);
    F.XN = (bf16*)(ws + WS_XN); F.QKV = (bf16*)(ws + WS_QKV); F.REST = (bf16*)(ws + WS_REST); F.A2 = (bf16*)(ws + WS_A2); F.Mb = (bf16*)(ws + WS_MB);
    const int lo = args.ph_lo, hi = args.ph_hi;
#define IN(k) (lo <= (k) && (k) < hi)
#define SEAM(k) do { if (IN(k) && IN((k) + 1)) grid.sync(); } while (0)
    const int gw = vcu * NWAVES + wave, NGW = G * NWAVES;
    if (IN(0)) { p0_prologue(F, lds, gw, NGW, wave, lane); SEAM(0); }
    if (IN(1)) {
        pg8::Gemm g{F.XN, F.WinT, M, NIN, D}; pg8::StaticOrder S; S.init(M, NIN, G, bx);
        pg8::EpiP E{F.QKV, F.REST};
        pg8::gemm_phase<pg8::EpiP, pg8::StaticOrder, true, true>(lds, g, S, E);
        SEAM(1);
    }
    if (IN(2)) {
        for (int u = vcu; u < BATCH * NH * (SEQ / 256); u += G) { const int g = u & 31, bh = u >> 5; att::unit(F, lds, bh >> 3, bh & 7, g); }
        conv_phase(F, bx * NTHR + tid, G * NTHR);
        SEAM(2);
    }
    if (IN(3)) {
        pg8::Gemm g{F.A2, F.Bt2, M, D, D}; pg8::StaticOrder S; S.init(M, D, G, bx);
        pg8::EpiM E{F.REST, F.Mb};
        pg8::gemm_phase<pg8::EpiM, pg8::StaticOrder, true, true>(lds, g, S, E);
        SEAM(3);
    }
    if (IN(4)) {
        pg8::Gemm g{F.Mb, F.WoutT, M, D, D}; pg8::StaticOrder S; S.init(M, D, G, bx);
        pg8::EpiV E{F.x, F.out, F.part};
        pg8::gemm_phase<pg8::EpiV, pg8::StaticOrder, true, true>(lds, g, S, E);
        SEAM(4);
    }
    if (IN(5)) final_norm(F, gw, NGW, lane);
#undef IN
#undef SEAM
}

extern "C" void kernel_launch(void* const* d_in, const int* in_sizes, int n_in, void* d_out, int out_size, void* d_ws, size_t ws_size, hipStream_t stream) {
    static int grid = 0;
    if (grid == 0) {
        if (n_in != 10 || in_sizes[0] != M * D || out_size != M * D || ws_size < WS_END) { fprintf(stderr, "kernel_launch: unexpected shapes (n_in %d in0 %d out %d ws %zu)\n", n_in, n_in > 0 ? in_sizes[0] : -1, out_size, ws_size); grid = -1; return; }
        int dev = 0, cus = 0, per_cu = 0;
        hipGetDevice(&dev); hipDeviceGetAttribute(&cus, hipDeviceAttributeMultiprocessorCount, dev);
        if (hipFuncSetAttribute((const void*)fwd_megakernel, hipFuncAttributeMaxDynamicSharedMemorySize, LDS_BYTES) != hipSuccess) { fprintf(stderr, "kernel_launch: hipFuncSetAttribute failed\n"); grid = -1; return; }
        if (hipOccupancyMaxActiveBlocksPerMultiprocessor(&per_cu, (const void*)fwd_megakernel, NTHR, LDS_BYTES) != hipSuccess || per_cu < 1) { fprintf(stderr, "kernel_launch: occupancy query says %d\n", per_cu); per_cu = 1; }
        (void)hipGetLastError();
        grid = cus * 1;
        fprintf(stderr, "kernel_launch: cus %d per_cu %d grid %d\n", cus, per_cu, grid);
    }
    if (grid < 0) return;
    Args a{};
    for (int i = 0; i < 10; ++i) a.in[i] = (const float*)d_in[i];
    a.out = (float*)d_out; a.ws = (unsigned char*)d_ws;
#if MK_N_LAUNCHES == 1
    a.ph_lo = 0; a.ph_hi = NPHASE;
    void* kargs[] = {&a};
    hipError_t e = hipLaunchCooperativeKernel((const void*)fwd_megakernel, dim3(grid), dim3(NTHR), kargs, LDS_BYTES, stream);
    if (e != hipSuccess) fprintf(stderr, "cooperative launch failed: %s (grid %d)\n", hipGetErrorString(e), grid);
#else
    for (int p = 0; p < NPHASE; ++p) { a.ph_lo = p; a.ph_hi = p + 1; hipLaunchKernelGGL(fwd_megakernel, dim3(grid), dim3(NTHR), LDS_BYTES, stream, a); }
#endif
}
```
